# Optimizing an MI355X kernel written in HIP

```python
import math
import jax, jax.numpy as jnp
from jax import lax
import numpy as np

D_MODEL = 2048
BATCH = 2
SEQ = 4096
DEPTH = 2

N_Q_HEADS = 16
N_KV_HEADS = 4
HEAD_DIM = 64
GROUP = N_Q_HEADS // N_KV_HEADS
ATTN_WIDTH = N_Q_HEADS * HEAD_DIM
KV_WIDTH = N_KV_HEADS * HEAD_DIM
WINDOW = 128
BLOCK = WINDOW
N_BUCKETS = 32
MAX_DISTANCE = 128
RNN_WIDTH = D_MODEL
RNN_BLOCKS = 16
RNN_BLOCK_DIM = RNN_WIDTH // RNN_BLOCKS
CONV_WIDTH = 4
LRU_C = 8.0
SPLITS = (ATTN_WIDTH, KV_WIDTH, KV_WIDTH, ATTN_WIDTH, RNN_WIDTH, RNN_WIDTH, D_MODEL, D_MODEL)
IN_WIDTH = sum(SPLITS)
SPLIT_POINTS = np.cumsum(SPLITS)[:-1].tolist()
DEEPNORM_ALPHA = (2.0 * DEPTH) ** 0.25
DEEPNORM_BETA = (8.0 * DEPTH) ** -0.25
LN_EPS = 1e-5
NEG_INF = -1e30

kernel_name = "hybrid_swa_sink_rglru_gated_deepnorm"


def t5_causal_bucket(dist):
    max_exact = N_BUCKETS // 2
    n = jnp.maximum(dist, 0)
    nf = jnp.maximum(n, max_exact).astype(jnp.float32)
    large = max_exact + (jnp.log(nf / max_exact) / math.log(MAX_DISTANCE / max_exact)
                         * (N_BUCKETS - max_exact)).astype(jnp.int32)
    large = jnp.minimum(large, N_BUCKETS - 1)
    return jnp.where(n < max_exact, n, large)


def layer_norm(x, g, b):
    xf = x.astype(jnp.float32)
    mu = xf.mean(-1, keepdims=True)
    var = jnp.square(xf - mu).mean(-1, keepdims=True)
    return ((xf - mu) * lax.rsqrt(var + LN_EPS) * g.astype(jnp.float32)
            + b.astype(jnp.float32)).astype(x.dtype)


def sliding_window_attention(q, k, v, sinks, rel_bias):
    B, S = q.shape[:2]
    nb = S // BLOCK
    qb = q.reshape(B, nb, BLOCK, N_KV_HEADS, GROUP, HEAD_DIM)
    pad = jnp.zeros((B, BLOCK, N_KV_HEADS, HEAD_DIM), k.dtype)

    def band(t):
        tp = jnp.concatenate([pad, t], axis=1).reshape(B, nb + 1, BLOCK, N_KV_HEADS, HEAD_DIM)
        return jnp.concatenate([tp[:, :-1], tp[:, 1:]], axis=2)

    kband, vband = band(k), band(v)
    s = jnp.einsum('bnqkgd,bnskd->bnkgqs', qb, kband).astype(jnp.float32) * (HEAD_DIM ** -0.5)

    qi = jnp.arange(BLOCK)[:, None]
    kj = jnp.arange(2 * BLOCK)[None, :]
    dist = qi + BLOCK - kj
    bias = rel_bias[t5_causal_bucket(dist)].astype(jnp.float32)
    bias = bias.transpose(2, 0, 1).reshape(N_KV_HEADS, GROUP, BLOCK, 2 * BLOCK)
    in_window = (dist >= 0) & (dist < WINDOW)
    key_pos = jnp.arange(nb)[:, None] * BLOCK + kj - BLOCK
    valid = in_window[None] & (key_pos >= 0)[:, None, :]
    s = jnp.where(valid[None, :, None, None], s + bias, NEG_INF)

    sink = sinks.astype(jnp.float32).reshape(N_KV_HEADS, GROUP)[None, None, :, :, None, None]
    m = jnp.maximum(s.max(-1, keepdims=True), sink)
    p = jnp.exp(s - m)
    denom = p.sum(-1, keepdims=True) + jnp.exp(sink - m)
    p = (p / denom).astype(v.dtype)
    o = jnp.einsum('bnkgqs,bnskd->bnqkgd', p, vband)
    return o.reshape(B, S, ATTN_WIDTH)


def causal_depthwise_conv(x, w, b):
    y = lax.conv_general_dilated(x, w[:, None, :], window_strides=(1,),
                                 padding=[(CONV_WIDTH - 1, 0)],
                                 dimension_numbers=('NWC', 'WIO', 'NWC'),
                                 feature_group_count=x.shape[-1])
    return y + b


def rg_lru(x, w_r, b_r, w_i, b_i, lam):
    B, S, _ = x.shape
    xb = x.reshape(B, S, RNN_BLOCKS, RNN_BLOCK_DIM)
    r = jax.nn.sigmoid(jnp.einsum('bshi,hij->bshj', xb, w_r).reshape(B, S, RNN_WIDTH) + b_r)
    i = jax.nn.sigmoid(jnp.einsum('bshi,hij->bshj', xb, w_i).reshape(B, S, RNN_WIDTH) + b_i)
    log_a = -LRU_C * r.astype(jnp.float32) * jax.nn.softplus(-lam.astype(jnp.float32))
    a = jnp.exp(log_a)
    u = jnp.sqrt(-jnp.expm1(2.0 * log_a)) * (i * x).astype(jnp.float32)

    def combine(left, right):
        a_l, h_l = left
        a_r, h_r = right
        return a_l * a_r, a_r * h_l + h_r

    _, h = lax.associative_scan(combine, (a, u), axis=1)
    return h.astype(x.dtype)


def hybrid_layer(x, w_in, conv_w, conv_b, w_r, b_r, w_i, b_i, lru_lambda, sinks,
                 w_attn_out, w_rnn_out, w_out, ln_g, ln_b, rel_bias):
    B, S, _ = x.shape
    proj = x @ w_in
    q, k, v, g_attn, x_rnn, g_rnn, m_attn, m_rnn = jnp.split(proj, SPLIT_POINTS, axis=-1)
    attn = sliding_window_attention(q.reshape(B, S, N_Q_HEADS, HEAD_DIM),
                                    k.reshape(B, S, N_KV_HEADS, HEAD_DIM),
                                    v.reshape(B, S, N_KV_HEADS, HEAD_DIM),
                                    sinks, rel_bias)
    y_attn = (attn * jax.nn.silu(g_attn)) @ w_attn_out
    h = rg_lru(causal_depthwise_conv(x_rnn, conv_w, conv_b), w_r, b_r, w_i, b_i, lru_lambda)
    y_rnn = (h * jax.nn.silu(g_rnn)) @ w_rnn_out
    mixed = jax.nn.sigmoid(m_attn) * y_attn + jax.nn.sigmoid(m_rnn) * y_rnn
    out = mixed @ w_out
    return layer_norm(DEEPNORM_ALPHA * x + out, ln_g, ln_b)


def setup_inputs(seed: int = 0) -> dict:
    key = jax.random.key(seed)
    ks = jax.random.split(key, 16)
    f32 = jnp.float32
    x = jax.random.normal(ks[0], (BATCH, SEQ, D_MODEL), f32)
    w_in = jax.random.normal(ks[1], (DEPTH, D_MODEL, IN_WIDTH), f32) * D_MODEL ** -0.5
    conv_w = jax.random.normal(ks[2], (DEPTH, CONV_WIDTH, RNN_WIDTH), f32) * CONV_WIDTH ** -0.5
    conv_b = jax.random.normal(ks[3], (DEPTH, RNN_WIDTH), f32) * 0.01
    w_r = jax.random.normal(ks[4], (DEPTH, RNN_BLOCKS, RNN_BLOCK_DIM, RNN_BLOCK_DIM), f32) * RNN_BLOCK_DIM ** -0.5
    b_r = jax.random.normal(ks[5], (DEPTH, RNN_WIDTH), f32) * 0.01
    w_i = jax.random.normal(ks[6], (DEPTH, RNN_BLOCKS, RNN_BLOCK_DIM, RNN_BLOCK_DIM), f32) * RNN_BLOCK_DIM ** -0.5
    b_i = jax.random.normal(ks[7], (DEPTH, RNN_WIDTH), f32) * 0.01
    u = jax.random.uniform(ks[8], (DEPTH, RNN_WIDTH), f32, minval=0.9, maxval=0.999)
    a = u ** (1.0 / LRU_C)
    lru_lambda = jnp.log(a) - jnp.log1p(-a)
    sinks = jax.random.normal(ks[9], (DEPTH, N_Q_HEADS), f32) * 0.5
    w_attn_out = jax.random.normal(ks[10], (DEPTH, ATTN_WIDTH, D_MODEL), f32) * ATTN_WIDTH ** -0.5
    w_rnn_out = jax.random.normal(ks[11], (DEPTH, RNN_WIDTH, D_MODEL), f32) * RNN_WIDTH ** -0.5
    w_out = jax.random.normal(ks[12], (DEPTH, D_MODEL, D_MODEL), f32) * (D_MODEL ** -0.5) * DEEPNORM_BETA
    ln_g = 1.0 + 0.02 * jax.random.normal(ks[13], (DEPTH, D_MODEL), f32)
    ln_b = 0.02 * jax.random.normal(ks[14], (DEPTH, D_MODEL), f32)
    rel_bias = jax.random.normal(ks[15], (N_BUCKETS, N_Q_HEADS), f32) * 0.5
    return {"x": x, "w_in": w_in, "conv_w": conv_w, "conv_b": conv_b, "w_r": w_r, "b_r": b_r,
            "w_i": w_i, "b_i": b_i, "lru_lambda": lru_lambda, "sinks": sinks,
            "w_attn_out": w_attn_out, "w_rnn_out": w_rnn_out, "w_out": w_out,
            "ln_g": ln_g, "ln_b": ln_b, "rel_bias": rel_bias}


def reference(x, w_in, conv_w, conv_b, w_r, b_r, w_i, b_i, lru_lambda, sinks,
              w_attn_out, w_rnn_out, w_out, ln_g, ln_b, rel_bias):
    for l in range(DEPTH):
        x = hybrid_layer(x, w_in[l], conv_w[l], conv_b[l], w_r[l], b_r[l], w_i[l], b_i[l],
                         lru_lambda[l], sinks[l], w_attn_out[l], w_rnn_out[l], w_out[l],
                         ln_g[l], ln_b[l], rel_bias)
    return x
```

```cpp
#include <hip/hip_runtime.h>
#include <cstdio>
#include <cstdint>

#ifndef MK_N_LAUNCHES
#define MK_N_LAUNCHES 0
#endif

namespace pg8 {
#define PG8_LAS __attribute__((address_space(3)))
typedef unsigned short bf16_t;
typedef short bf16x8 __attribute__((ext_vector_type(8)));
typedef float f32x4 __attribute__((ext_vector_type(4)));
typedef unsigned u32x4 __attribute__((ext_vector_type(4)));
typedef unsigned u32x2 __attribute__((ext_vector_type(2)));
constexpr int BM = 256, BK = 64, HALF = 128, HTB = HALF * BK * 2, STAGE_BYTES = 8 * HTB, NXCD = 8, WGM = 8;

__host__ __device__ __forceinline__ int lds_byte(int r, int c) { const int st = (r >> 4) * 2 + (c >> 5), rr = r & 15, cc = c & 31, ob = rr * 64 + cc * 2; return st * 1024 + (ob ^ (((ob >> 9) & 1) << 5)); }
__host__ __device__ __forceinline__ void stage_rc(int b, int& R, int& C) { const int st = b / 1024, sb = b % 1024, swz = sb ^ (((sb >> 9) & 1) << 5); R = (st >> 1) * 16 + swz / 64; C = (st & 1) * 32 + (swz % 64) / 2; }
__host__ __device__ __forceinline__ int perm32(int rho) { const int n = rho >> 4, i = rho & 15; return 8 * (i >> 2) + 4 * n + (i & 3); }

struct Unit { int pm, pn; };
struct Gemm { const bf16_t* A; const bf16_t* Bt; int M, N, K; };

struct StaticOrder {
    int nM, nN, nwg, G, c;
    __host__ __device__ void init(int M, int N, int G_, int c_) { nM = M / BM; nN = N / BM; nwg = nM * nN; G = G_; c = c_; }
    __host__ __device__ bool next(int i, Unit& u) const {
        const long L = (long)i * G + c; if (L >= nwg) return false;
        int wgid = (int)L; { const int q = nwg / NXCD, r = nwg % NXCD, xcd = wgid % NXCD, off = wgid / NXCD; wgid = (xcd < r ? xcd * (q + 1) : r * (q + 1) + (xcd - r) * q) + off; }
        const int nig = WGM * nN, gid = wgid / nig, fm = gid * WGM, gsz = (nM - fm) < WGM ? (nM - fm) : WGM;
        u.pm = fm + ((wgid % nig) % gsz); u.pn = (wgid % nig) / gsz; return true;
    }
};

__device__ __forceinline__ unsigned cvt_pk_bf16(float lo, float hi) { unsigned r; asm volatile("v_cvt_pk_bf16_f32 %0, %1, %2" : "=v"(r) : "v"(lo), "v"(hi)); return r; }
__device__ __forceinline__ float bf_lo(unsigned w) { return __builtin_bit_cast(float, w << 16); }
__device__ __forceinline__ float bf_hi(unsigned w) { return __builtin_bit_cast(float, w & 0xffff0000u); }
__device__ __forceinline__ float sigm(float x) { return __builtin_amdgcn_rcpf(1.0f + __builtin_amdgcn_exp2f(-1.4426950408889634f * x)); }


struct EpiProj {
    static constexpr bool PERM = true, AFTER_DRAIN = false, HAS_MID = false;
    bf16_t* O; int ldc; float qscale;
    __device__ __forceinline__ void mid(f32x4 (&)[2][2][4][2], const Unit&, int, int, int, int) const {}
    __device__ __forceinline__ void operator()(const f32x4 (&acc)[2][2][4][2], const Unit& u, int wr, int wc, int fr, int fq) const {
        const int row0 = u.pm * BM + wr * 64 + fr, col0 = u.pn * BM + wc * 32 + 8 * fq, pn = u.pn;
        const int mode = (pn < 4) ? 0 : (pn < 6) ? 1 : (pn < 10) ? 2 : (pn < 18) ? 1 : (pn < 26) ? 2 : 3;
        const float sc = (mode == 0) ? qscale : 1.0f;
#pragma unroll
        for (int ai = 0; ai < 2; ++ai)
#pragma unroll
            for (int m = 0; m < 4; ++m) { bf16_t* rowp = O + (size_t)(row0 + ai * HALF + m * 16) * ldc + col0;
#pragma unroll
                for (int bj = 0; bj < 2; ++bj) { f32x4 v0 = acc[ai][bj][m][0], v1 = acc[ai][bj][m][1];
                    if (mode == 2) {
#pragma unroll
                        for (int e = 0; e < 4; ++e) { v0[e] = v0[e] * sigm(v0[e]); v1[e] = v1[e] * sigm(v1[e]); }
                    } else if (mode == 3) {
#pragma unroll
                        for (int e = 0; e < 4; ++e) { v0[e] = sigm(v0[e]); v1[e] = sigm(v1[e]); }
                    } else { v0 = v0 * sc; v1 = v1 * sc; }
                    u32x4 w; w.x = cvt_pk_bf16(v0[0], v0[1]); w.y = cvt_pk_bf16(v0[2], v0[3]); w.z = cvt_pk_bf16(v1[0], v1[1]); w.w = cvt_pk_bf16(v1[2], v1[3]);
                    *(u32x4*)(rowp + bj * HALF) = w; } }
    }
};

struct EpiMixed {
    static constexpr bool PERM = true, AFTER_DRAIN = false, HAS_MID = true;
    const bf16_t* P; int ldp, off_a, off_r; bf16_t* O; int ldc; int mid_t;
    __device__ __forceinline__ void mid(f32x4 (&acc)[2][2][4][2], const Unit& u, int wr, int wc, int fr, int fq) const {
        int row0 = u.pm * BM + wr * 64 + fr, col0 = u.pn * BM + wc * 32 + 8 * fq;
        asm volatile("" : "+v"(row0), "+v"(col0));
#pragma unroll
        for (int ai = 0; ai < 2; ++ai)
#pragma unroll
            for (int m = 0; m < 4; ++m) { const bf16_t* rowp = P + (size_t)(row0 + ai * HALF + m * 16) * ldp + col0;
#pragma unroll
                for (int bj = 0; bj < 2; ++bj) { const u32x4 a = *(const u32x4*)(rowp + off_a + bj * HALF), r = *(const u32x4*)(rowp + off_r + bj * HALF);
                    f32x4 q0, q1;
                    q0[0] = bf_lo(a.x) * __builtin_amdgcn_rcpf(fmaxf(bf_lo(r.x), 1e-30f)); q0[1] = bf_hi(a.x) * __builtin_amdgcn_rcpf(fmaxf(bf_hi(r.x), 1e-30f));
                    q0[2] = bf_lo(a.y) * __builtin_amdgcn_rcpf(fmaxf(bf_lo(r.y), 1e-30f)); q0[3] = bf_hi(a.y) * __builtin_amdgcn_rcpf(fmaxf(bf_hi(r.y), 1e-30f));
                    q1[0] = bf_lo(a.z) * __builtin_amdgcn_rcpf(fmaxf(bf_lo(r.z), 1e-30f)); q1[1] = bf_hi(a.z) * __builtin_amdgcn_rcpf(fmaxf(bf_hi(r.z), 1e-30f));
                    q1[2] = bf_lo(a.w) * __builtin_amdgcn_rcpf(fmaxf(bf_lo(r.w), 1e-30f)); q1[3] = bf_hi(a.w) * __builtin_amdgcn_rcpf(fmaxf(bf_hi(r.w), 1e-30f));
                    acc[ai][bj][m][0] = acc[ai][bj][m][0] * q0; acc[ai][bj][m][1] = acc[ai][bj][m][1] * q1; }
                asm volatile("" ::: "memory"); }
    }
    __device__ __forceinline__ void operator()(const f32x4 (&acc)[2][2][4][2], const Unit& u, int wr, int wc, int fr, int fq) const {
        const int row0 = u.pm * BM + wr * 64 + fr, col0 = u.pn * BM + wc * 32 + 8 * fq;
#pragma unroll
        for (int ai = 0; ai < 2; ++ai)
#pragma unroll
            for (int m = 0; m < 4; ++m) { const size_t row = (size_t)(row0 + ai * HALF + m * 16);
#pragma unroll
                for (int bj = 0; bj < 2; ++bj) { const u32x4 r = *(const u32x4*)(P + row * ldp + off_r + col0 + bj * HALF);
                    const f32x4 v0 = acc[ai][bj][m][0], v1 = acc[ai][bj][m][1];
                    u32x4 w; w.x = cvt_pk_bf16(v0[0] * bf_lo(r.x), v0[1] * bf_hi(r.x)); w.y = cvt_pk_bf16(v0[2] * bf_lo(r.y), v0[3] * bf_hi(r.y));
                    w.z = cvt_pk_bf16(v1[0] * bf_lo(r.z), v1[1] * bf_hi(r.z)); w.w = cvt_pk_bf16(v1[2] * bf_lo(r.w), v1[3] * bf_hi(r.w));
                    *(u32x4*)(O + row * ldc + col0 + bj * HALF) = w; }
                asm volatile("" ::: "memory"); }
    }
};

struct EpiResF32 {
    static constexpr bool PERM = false, AFTER_DRAIN = false, HAS_MID = false;
    const float* X; float* V; int ldc; float alpha;
    __device__ __forceinline__ void mid(f32x4 (&)[2][2][4][2], const Unit&, int, int, int, int) const {}
    __device__ __forceinline__ void operator()(const f32x4 (&acc)[2][2][4][2], const Unit& u, int wr, int wc, int fr, int fq) const {
        const int row0 = u.pm * BM + wr * 64 + fr, col0 = u.pn * BM + wc * 32 + 4 * fq;
#pragma unroll
        for (int ai = 0; ai < 2; ++ai)
#pragma unroll
            for (int m = 0; m < 4; ++m) { const size_t off = (size_t)(row0 + ai * HALF + m * 16) * ldc + col0;
#pragma unroll
                for (int bj = 0; bj < 2; ++bj)
#pragma unroll
                    for (int n = 0; n < 2; ++n) { const f32x4 xv = *(const f32x4*)(X + off + bj * HALF + n * 16); *(f32x4*)(V + off + bj * HALF + n * 16) = xv * alpha + acc[ai][bj][m][n]; }
                asm volatile("" ::: "memory"); }
    }
};

template <class Epi, class Sched, bool ALIGN_EPI>
__device__ __forceinline__ void gemm_phase(PG8_LAS unsigned char* lds, const Gemm g, const Sched& S, const Epi& E) {
    int tid = threadIdx.x; asm volatile("" : "+v"(tid));
    const int wid = __builtin_amdgcn_readfirstlane(tid >> 6), lane = tid & 63, wr = wid >> 2, wc = wid & 3, fr = lane & 15, fq = lane >> 4;
    const int K = g.K, nt = K / BK;
    unsigned voffA[2], voffB[2];
#pragma unroll
    for (int i = 0; i < 2; ++i) { int R, C; stage_rc(tid * 16 + i * 8192, R, C); const int Rb = Epi::PERM ? ((R & ~31) + perm32(R & 31)) : R;
        voffA[i] = (unsigned)(R * K + C) * 2u; voffB[i] = (unsigned)(Rb * K + C) * 2u; }
    const size_t kstep = (size_t)(BK * 2);
    const size_t hstep = (size_t)HALF * K * 2;
    const size_t tstep = 2 * hstep;
    const unsigned ldsw = (unsigned)wid * 1024u;
    const int aoff = lds_byte(wr * 64 + fr, fq * 8), boff = lds_byte(wc * 32 + fr, fq * 8);
#define PG8_SA(b, h) (((b) * 2 + (h)) * HTB)
#define PG8_SB(b, h) ((4 + (b) * 2 + (h)) * HTB)
#define PG8_STAGE(bufoff, gbase, voff) do { _Pragma("unroll") for (int _i = 0; _i < 2; ++_i) \
        __builtin_amdgcn_global_load_lds((const unsigned*)((const char*)(gbase) + (voff)[_i]), (PG8_LAS unsigned*)(lds + (bufoff) + ldsw + _i * 8192), 16, 0, 0); } while (0)
#define PG8_LDA(dst, b, h) do { _Pragma("unroll") for (int m = 0; m < 4; ++m) _Pragma("unroll") for (int k = 0; k < 2; ++k) dst[m][k] = *(const PG8_LAS bf16x8*)(lds + PG8_SA(b, h) + aoff + m * 2048 + k * 1024); } while (0)
#define PG8_LDB(dst, b, h) do { _Pragma("unroll") for (int n = 0; n < 2; ++n) _Pragma("unroll") for (int k = 0; k < 2; ++k) dst[n][k] = *(const PG8_LAS bf16x8*)(lds + PG8_SB(b, h) + boff + n * 2048 + k * 1024); } while (0)
#define PG8_MMA(ai, bj, At, Bt) do { __builtin_amdgcn_s_setprio(1); _Pragma("unroll") for (int m = 0; m < 4; ++m) _Pragma("unroll") for (int n = 0; n < 2; ++n) _Pragma("unroll") for (int k = 0; k < 2; ++k) \
        acc[ai][bj][m][n] = __builtin_amdgcn_mfma_f32_16x16x32_bf16(Bt[n][k], At[m][k], acc[ai][bj][m][n], 0, 0, 0); __builtin_amdgcn_s_setprio(0); } while (0)
#define PG8_WAIT_V(n) asm volatile("s_waitcnt vmcnt(" #n ")" ::: "memory")
#define PG8_WAIT_L(n) asm volatile("s_waitcnt lgkmcnt(" #n ")" ::: "memory")
#define PG8_BAR __builtin_amdgcn_s_barrier()
#define PG8_SCHED __builtin_amdgcn_sched_barrier(0)
    Unit cur, nxt; int ui = 0;
    if (!S.next(0, cur)) return;
    f32x4 acc[2][2][4][2];
#pragma unroll
    for (int a = 0; a < 2; ++a)
#pragma unroll
        for (int b = 0; b < 2; ++b)
#pragma unroll
            for (int m = 0; m < 4; ++m)
#pragma unroll
                for (int n = 0; n < 2; ++n) acc[a][b][m][n] = (f32x4){0.f, 0.f, 0.f, 0.f};
    bf16x8 At[4][2], B0[2][2], B1[2][2];
    const char* cA = (const char*)g.A + (size_t)cur.pm * tstep; const char* cB = (const char*)g.Bt + (size_t)cur.pn * tstep;
    PG8_STAGE(PG8_SB(0, 0), cB, voffB); PG8_STAGE(PG8_SB(0, 1), cB + hstep, voffB); PG8_STAGE(PG8_SA(0, 0), cA, voffA); PG8_STAGE(PG8_SA(0, 1), cA + hstep, voffA);
    if (wr == 1) PG8_BAR;
    PG8_WAIT_V(2); PG8_BAR;
    PG8_STAGE(PG8_SB(1, 0), cB + kstep, voffB); PG8_STAGE(PG8_SA(1, 0), cA + kstep, voffA); PG8_STAGE(PG8_SB(1, 1), cB + hstep + kstep, voffB);
    PG8_WAIT_V(6); PG8_BAR;
    for (;;) {
        const bool has_next = S.next(ui + 1, nxt);
        const char* nA = has_next ? (const char*)g.A + (size_t)nxt.pm * tstep : cA; const char* nB = has_next ? (const char*)g.Bt + (size_t)nxt.pn * tstep : cB;
#define PG8_KPAIR(t) do { \
            const bool last = ((t) == nt - 2); \
            const char* a1 = cA + (size_t)((t) + 1) * kstep; \
            const char* a2 = last ? nA : cA + (size_t)((t) + 2) * kstep; const char* b2 = last ? nB : cB + (size_t)((t) + 2) * kstep; \
            const char* a3 = a2 + kstep; const char* b3 = b2 + kstep; \
            PG8_LDB(B0, 0, 0); PG8_LDB(B1, 0, 1); PG8_SCHED; PG8_LDA(At, 0, 0); PG8_STAGE(PG8_SA(1, 1), a1 + hstep, voffA); \
            PG8_WAIT_V(8); PG8_WAIT_L(0); PG8_BAR; PG8_MMA(0, 0, At, B0); PG8_MMA(0, 1, At, B1); PG8_BAR; PG8_SCHED; \
            PG8_LDA(At, 0, 1); PG8_STAGE(PG8_SB(0, 0), b2, voffB); PG8_STAGE(PG8_SB(0, 1), b2 + hstep, voffB); PG8_STAGE(PG8_SA(0, 0), a2, voffA); \
            PG8_WAIT_V(8); PG8_WAIT_L(0); PG8_BAR; PG8_MMA(1, 0, At, B0); PG8_MMA(1, 1, At, B1); PG8_BAR; PG8_SCHED; \
            PG8_LDB(B0, 1, 0); PG8_LDB(B1, 1, 1); PG8_SCHED; PG8_LDA(At, 1, 0); PG8_STAGE(PG8_SA(0, 1), a2 + hstep, voffA); \
            PG8_WAIT_V(8); PG8_WAIT_L(0); PG8_BAR; PG8_MMA(0, 0, At, B0); PG8_MMA(0, 1, At, B1); PG8_BAR; PG8_SCHED; \
            PG8_LDA(At, 1, 1); PG8_STAGE(PG8_SB(1, 0), b3, voffB); PG8_STAGE(PG8_SB(1, 1), b3 + hstep, voffB); PG8_STAGE(PG8_SA(1, 0), a3, voffA); \
            PG8_WAIT_V(8); PG8_WAIT_L(0); PG8_BAR; PG8_MMA(1, 0, At, B0); PG8_MMA(1, 1, At, B1); PG8_BAR; PG8_SCHED; } while (0)
        if constexpr (Epi::HAS_MID) {
            const int mt = E.mid_t;
            for (int t = 0; t < mt; t += 2) PG8_KPAIR(t);
            E.mid(acc, cur, wr, wc, fr, fq);
            for (int t = mt; t < nt; t += 2) PG8_KPAIR(t);
        } else {
            for (int t = 0; t < nt; t += 2) PG8_KPAIR(t);
        }
        if constexpr (ALIGN_EPI) { if (wr == 0) PG8_BAR; }
        if constexpr (!Epi::AFTER_DRAIN) { E(acc, cur, wr, wc, fr, fq); }
        if (!has_next) break;
#pragma unroll
        for (int a = 0; a < 2; ++a)
#pragma unroll
            for (int b = 0; b < 2; ++b)
#pragma unroll
                for (int m = 0; m < 4; ++m)
#pragma unroll
                    for (int n = 0; n < 2; ++n) acc[a][b][m][n] = (f32x4){0.f, 0.f, 0.f, 0.f};
        cur = nxt; cA = nA; cB = nB; ++ui;
        if constexpr (ALIGN_EPI) { if (wr == 1) PG8_BAR; }
    }
    PG8_WAIT_V(0);
    if constexpr (!ALIGN_EPI) { if (wr == 0) PG8_BAR; }
    PG8_BAR;
    if constexpr (Epi::AFTER_DRAIN) { E.fused(acc, cur, wr, wc, fr, fq, lds, wid, lane); }
#undef PG8_KPAIR
#undef PG8_SA
#undef PG8_SB
#undef PG8_STAGE
#undef PG8_LDA
#undef PG8_LDB
#undef PG8_MMA
#undef PG8_WAIT_V
#undef PG8_WAIT_L
#undef PG8_BAR
#undef PG8_SCHED
}
}

constexpr int NWAVES = 8, NTHREADS = 512;
constexpr int BATCH = 2, SEQ = 4096, D = 2048, DEPTH = 2, M = BATCH * SEQ;
constexpr int NQH = 16, NKVH = 4, HD = 64, AW = 1024, KVW = 256, RW = 2048, RBLK = 16, RBD = 128;
constexpr int NIN = 10752;
constexpr int OFF_Q = 0, OFF_K = 1024, OFF_V = 1280, OFF_GA = 1536, OFF_XR = 2560, OFF_GR = 4608, OFF_MA = 6656, OFF_MR = 8704;
constexpr int KCAT = AW + RW;
constexpr float LN_EPS = 1e-5f, ALPHA = 1.4142135623730951f, LOG2E = 1.4426950408889634f;
constexpr float QSCALE = 0.125f * 1.4426950408889634f;
constexpr int CH = 64, NCHUNK = SEQ / CH;

constexpr size_t MiB = 1u << 20;
constexpr size_t WS_CTL = 0, CTL_ZERO_BYTES = 1 * MiB;
constexpr size_t WS_TAB = 1 * MiB;
constexpr size_t WS_WIN = 2 * MiB;
constexpr size_t WS_WCAT = WS_WIN + 84 * MiB;
constexpr size_t WS_WOUT = WS_WCAT + 24 * MiB;
constexpr size_t WS_WG = WS_WOUT + 16 * MiB;
constexpr size_t WS_XB = WS_WG + 2 * MiB;
constexpr size_t WS_P = WS_XB + 32 * MiB;
constexpr size_t WS_ACAT = WS_P + 168 * MiB;
constexpr size_t WS_MIX = WS_ACAT + 48 * MiB;
constexpr size_t WS_HL = WS_MIX + 32 * MiB;
constexpr size_t WS_PC = WS_HL + 64 * MiB;
constexpr size_t WS_SUM = WS_PC + 64 * MiB;
constexpr size_t WS_X1 = WS_SUM + 2 * MiB;
constexpr size_t WS_END = WS_X1 + 64 * MiB;
constexpr int TAB_NEG8SP = 0, TAB_BIAS2 = 4096, TAB_SINK2 = 4096 + 2048;
constexpr int CW_BAR = 4096;

constexpr int RING_BYTES = 131072;
constexpr int LDSCTL_OFF = RING_BYTES, MISC_OFF = LDSCTL_OFF + 320;
constexpr int LDS_BYTES = 147456;

#define GAS __attribute__((address_space(1)))
#define LAS __attribute__((address_space(3)))
typedef unsigned short bf16;
typedef unsigned v4u __attribute__((ext_vector_type(4)));
typedef unsigned v2u __attribute__((ext_vector_type(2)));
typedef float f32x4 __attribute__((ext_vector_type(4)));
typedef float f32x16 __attribute__((ext_vector_type(16)));
typedef short bf16x8 __attribute__((ext_vector_type(8)));
typedef GAS unsigned gu32;
#define RLX_AGENT __ATOMIC_RELAXED, __HIP_MEMORY_SCOPE_AGENT
#define LDS_WAIT() asm volatile("s_waitcnt lgkmcnt(0)" ::: "memory")
__device__ __forceinline__ unsigned f2bf(float f) { unsigned u = __builtin_bit_cast(unsigned, f); return (u + 0x7fffu + ((u >> 16) & 1u)) >> 16; }
__device__ __forceinline__ unsigned pk2(float lo, float hi) { return f2bf(lo) | (f2bf(hi) << 16); }
__device__ __forceinline__ float bf2f(unsigned short h) { return __builtin_bit_cast(float, (unsigned)h << 16); }
__device__ __forceinline__ float bflo(unsigned w) { return __builtin_bit_cast(float, w << 16); }
__device__ __forceinline__ float bfhi(unsigned w) { return __builtin_bit_cast(float, w & 0xffff0000u); }

#define XB_TMO      128
#define XB_XCNT(j)  (256  + 64 * (j))
#define XB_XSUB(j)  (1280 + 64 * (j))
#define XB_XGEN(j)  (2304 + 64 * (j))
#define XB_TOP      3328
#define XB_TOPGEN   3392
#define XCD_BAR_WORDS 3456
#define XB_SPIN_CAP (1u << 18)
__device__ __forceinline__ unsigned xb_ld(unsigned* p)              { return __hip_atomic_load(p, __ATOMIC_RELAXED, __HIP_MEMORY_SCOPE_AGENT); }
__device__ __forceinline__ unsigned xb_add(unsigned* p, unsigned v) { return __hip_atomic_fetch_add(p, v, __ATOMIC_RELAXED, __HIP_MEMORY_SCOPE_AGENT); }
__device__ __forceinline__ unsigned xb_xcc_id() { return (unsigned)__builtin_amdgcn_s_getreg((3 << 11) | 20) & 0xFu; }
#define XB_SPIN(cond, bar) do { unsigned _sp = 0; while (cond) { __builtin_amdgcn_s_sleep(1); \
    if ((++_sp & 255u) == 0u) { if (xb_ld(&(bar)[XB_TMO])) break; if (_sp > XB_SPIN_CAP) { atomicAdd(&(bar)[XB_TMO], 1u); break; } } } } while (0)
struct XcdBarrier { unsigned* bar; unsigned x; volatile LAS unsigned* st; };
__device__ __forceinline__ XcdBarrier xcd_barrier_post(unsigned* bar, volatile LAS unsigned* st) {
    XcdBarrier b; b.bar = bar; b.x = xb_xcc_id(); b.st = st;
    if (threadIdx.x == 0) (void)xb_add(&bar[XB_XCNT(b.x)], 1u);
    return b;
}
__device__ __forceinline__ void xcd_barrier_complete(unsigned* bar, unsigned x, unsigned& nloc, unsigned& nx) {
    const unsigned G = gridDim.x * gridDim.y * gridDim.z;
    unsigned sum, cnt, mine, sp = 0u;
    for (;;) {
        sum = 0u; cnt = 0u; mine = 0u;
#pragma unroll
        for (unsigned j = 0; j < 16; ++j) { const unsigned c = xb_ld(&bar[XB_XCNT(j)]); sum += c; cnt += (c > 0u) ? 1u : 0u; mine = (j == x) ? c : mine; }
        if (sum == G) break;
        __builtin_amdgcn_s_sleep(1);
        if ((++sp & 255u) == 0u) { if (xb_ld(&bar[XB_TMO])) break; if (sp > XB_SPIN_CAP) { atomicAdd(&bar[XB_TMO], 1u); break; } }
    }
    nloc = mine > 0u ? mine : 1u; nx = cnt > 0u ? cnt : 1u;
}
__device__ __forceinline__ void xcd_barrier(const XcdBarrier& b) {
    asm volatile("s_waitcnt vmcnt(0)" ::: "memory");
    __syncthreads();
    if (threadIdx.x == 0) {
        unsigned* bar = b.bar;
        __builtin_amdgcn_s_waitcnt(0);
        unsigned nloc = b.st[0], nx = b.st[1];
        if (nloc == 0u) { xcd_barrier_complete(bar, b.x, nloc, nx); b.st[0] = nloc; b.st[1] = nx; }
        const unsigned old = xb_add(&bar[XB_XSUB(b.x)], 1u);
        const unsigned gen = old / nloc;
        if (old + 1u == (gen + 1u) * nloc) {
            __builtin_amdgcn_fence(__ATOMIC_RELEASE, "agent");
            asm volatile("s_waitcnt vmcnt(0)" ::: "memory");
            const unsigned og = xb_add(&bar[XB_TOP], 1u);
            const unsigned tg = og / nx;
            if (og + 1u == (tg + 1u) * nx) xb_add(&bar[XB_TOPGEN], 1u);
            else XB_SPIN(xb_ld(&bar[XB_TOPGEN]) == tg, bar);
            __builtin_amdgcn_fence(__ATOMIC_ACQUIRE, "agent");
            xb_add(&bar[XB_XGEN(b.x)], 1u);
            asm volatile("s_waitcnt vmcnt(0)" ::: "memory");
        } else {
            XB_SPIN(xb_ld(&bar[XB_XGEN(b.x)]) == gen, bar);
            __builtin_amdgcn_fence(__ATOMIC_ACQUIRE, "agent");
            asm volatile("s_waitcnt vmcnt(0)" ::: "memory");
        }
    }
    __syncthreads();
}

struct Args { const float* in[16]; float* out; unsigned char* ws; int ph_lo, ph_hi; };
struct Frame {
    LAS unsigned char* lds;
    int vcu, G;
    unsigned char* ws;
};
__device__ __forceinline__ int opaque_tid() { int t = threadIdx.x; asm volatile("" : "+v"(t)); return t; }
#define TID_LANE_WAVE() const int tid = opaque_tid(), lane = tid & 63, wave = __builtin_amdgcn_readfirstlane(tid >> 6); (void)lane; (void)wave

__device__ __forceinline__ float wave_sum(float v) {
#pragma unroll
    for (int o = 1; o < 64; o <<= 1) v += __shfl_xor(v, o);
    return v;
}

__device__ __forceinline__ void p0_transpose_item(const float* W, int N, bf16* WT, int dpitch, int coff, LAS float* scr, int item, int lane) {
    const int nblk = N / 32, kb = item / nblk, nb = item % nblk, k0 = 64 * kb, n0 = 32 * nb;
#pragma unroll 8
    for (int i = 0; i < 32; ++i) { const int kk = 2 * i + (lane >> 5); scr[kk * 33 + (lane & 31)] = W[(size_t)(k0 + kk) * N + n0 + (lane & 31)]; }
    LDS_WAIT(); asm volatile("" ::: "memory");
    const int c = lane & 7;
#pragma unroll
    for (int j = 0; j < 4; ++j) { const int n = (lane >> 3) + 8 * j; const LAS float* s = scr + (8 * c) * 33 + n;
        v4u o; o.x = pk2(s[0 * 33], s[1 * 33]); o.y = pk2(s[2 * 33], s[3 * 33]); o.z = pk2(s[4 * 33], s[5 * 33]); o.w = pk2(s[6 * 33], s[7 * 33]);
        *(GAS v4u*)(WT + (size_t)(n0 + n) * dpitch + coff + k0 + 8 * c) = o; }
    LDS_WAIT(); asm volatile("" ::: "memory");
}
__device__ __forceinline__ int t5_bucket(int n) {
    if (n < 16) return n;
    const float v = logf((float)n / 16.0f) / 2.0794415416798357f * 16.0f;
    int l = 16 + (int)v; return l < 31 ? l : 31;
}
__device__ __forceinline__ void p0_prologue(Frame& F, const Args& a) {
    TID_LANE_WAVE();
    LAS float* scr = (LAS float*)(F.lds + wave * 16384);
    const int gw = F.vcu * NWAVES + wave, NGW = F.G * NWAVES;
    constexpr int I_IN = (D / 64) * (NIN / 32), I_AO = (AW / 64) * (D / 32), I_RO = (RW / 64) * (D / 32), I_O = (D / 64) * (D / 32), I_G = 2 * RBLK * 2 * 4;
    constexpr int PER_LAYER = I_IN + I_AO + I_RO + I_O + I_G, NITEMS = DEPTH * PER_LAYER;
    for (int it = gw; it < NITEMS; it += NGW) {
        const int l = it / PER_LAYER; int r = it % PER_LAYER;
        bf16* win = (bf16*)(F.ws + WS_WIN) + (size_t)l * NIN * D; bf16* wcat = (bf16*)(F.ws + WS_WCAT) + (size_t)l * D * KCAT;
        bf16* wout = (bf16*)(F.ws + WS_WOUT) + (size_t)l * D * D; bf16* wg = (bf16*)(F.ws + WS_WG) + (size_t)l * RBLK * 256 * RBD;
        if (r < I_IN) { p0_transpose_item(a.in[1] + (size_t)l * D * NIN, NIN, win, D, 0, scr, r, lane); continue; } r -= I_IN;
        if (r < I_AO) { p0_transpose_item(a.in[10] + (size_t)l * AW * D, D, wcat, KCAT, 0, scr, r, lane); continue; } r -= I_AO;
        if (r < I_RO) { p0_transpose_item(a.in[11] + (size_t)l * RW * D, D, wcat, KCAT, AW, scr, r, lane); continue; } r -= I_RO;
        if (r < I_O)  { p0_transpose_item(a.in[12] + (size_t)l * D * D, D, wout, D, 0, scr, r, lane); continue; } r -= I_O;
        { const int gate = r / (RBLK * 8), hb = (r / 8) % RBLK, sub = r % 8;
          const float* src = (gate ? a.in[6] : a.in[4]) + ((size_t)l * RBLK + hb) * RBD * RBD;
          p0_transpose_item(src, RBD, wg + ((size_t)hb * 256 + gate * 128) * RBD, RBD, 0, scr, sub, lane); }
    }
    for (int m = gw; m < M; m += NGW) {
        const GAS f32x4* xr = (const GAS f32x4*)(a.in[0] + (size_t)m * D) + lane;
        GAS v2u* o8 = (GAS v2u*)((bf16*)(F.ws + WS_XB) + (size_t)m * D) + lane;
#pragma unroll
        for (int j = 0; j < 8; ++j) { const f32x4 v = xr[64 * j]; v2u w; w.x = pk2(v.x, v.y); w.y = pk2(v.z, v.w); o8[64 * j] = w; }
    }
    float* tab = (float*)(F.ws + WS_TAB);
    const int gt = F.vcu * NTHREADS + tid, NGT = F.G * NTHREADS;
    for (int i = gt; i < DEPTH * RW; i += NGT) { const float lam = a.in[8][i]; const float sp = (lam < -20.f) ? -lam : log1pf(expf(-lam)); tab[TAB_NEG8SP + i] = -8.0f * sp; }
    for (int i = gt; i < NQH * 128; i += NGT) { const int h = i >> 7, dist = i & 127; tab[TAB_BIAS2 + i] = a.in[15][t5_bucket(dist) * NQH + h] * LOG2E; }
    for (int i = gt; i < DEPTH * NQH; i += NGT) tab[TAB_SINK2 + i] = a.in[9][i] * LOG2E;
}

__device__ __forceinline__ int crow(int r, int hi) { return (r & 3) + 8 * (r >> 2) + 4 * hi; }
constexpr int VT_PITCH = 196;
constexpr int ATT_VT = 0, ATT_BIAS = 64 * VT_PITCH * 2  , ATT_END = ATT_BIAS + 4 * 128 * 4;
__device__ __forceinline__ void attn_unit(Frame& F, int layer, int unit) {
    const int qblk = unit & 63, kvh = (unit >> 6) & 3, b = unit >> 8;
    const bf16* P = (const bf16*)(F.ws + WS_P); bf16* AC = (bf16*)(F.ws + WS_ACAT);
    const float* tab = (const float*)(F.ws + WS_TAB);
    LAS bf16* vt = (LAS bf16*)(F.lds + ATT_VT); LAS float* bs = (LAS float*)(F.lds + ATT_BIAS);
    TID_LANE_WAVE();
    const int w = wave, r32 = lane & 31, hi = lane >> 5;
    const size_t rowbase = (size_t)b * SEQ; const int kv0 = qblk * 64 - 128;
#pragma unroll
    for (int p = 0; p < 3; ++p) { const int key = 64 * p + lane, kpos = kv0 + key;
        v4u v = (v4u){0u, 0u, 0u, 0u};
        if (kpos >= 0) v = *(const GAS v4u*)(P + (rowbase + kpos) * NIN + OFF_V + kvh * 64 + w * 8);
        LAS bf16* dst = vt + (w * 8) * VT_PITCH + key;
        dst[0 * VT_PITCH] = (bf16)(v.x & 0xffffu); dst[1 * VT_PITCH] = (bf16)(v.x >> 16); dst[2 * VT_PITCH] = (bf16)(v.y & 0xffffu); dst[3 * VT_PITCH] = (bf16)(v.y >> 16);
        dst[4 * VT_PITCH] = (bf16)(v.z & 0xffffu); dst[5 * VT_PITCH] = (bf16)(v.z >> 16); dst[6 * VT_PITCH] = (bf16)(v.w & 0xffffu); dst[7 * VT_PITCH] = (bf16)(v.w >> 16); }
    bs[tid] = tab[TAB_BIAS2 + (kvh * 4) * 128 + tid];
    const int hq = kvh * 4 + (w & 3), sub = w >> 2, q0 = qblk * 64 + sub * 32;
    const float sink2 = tab[TAB_SINK2 + layer * NQH + hq];
    bf16x8 qf[4];
    { const bf16* qp = P + (rowbase + q0 + r32) * NIN + OFF_Q + hq * 64 + hi * 8;
#pragma unroll
      for (int d0 = 0; d0 < 4; ++d0) qf[d0] = *(const GAS bf16x8*)(qp + d0 * 16); }
    f32x16 s[5];
#pragma unroll
    for (int i = 0; i < 5; ++i) {
        const int kpos = q0 - 128 + 32 * i + r32; const bool ok = kpos >= 0;
        const bf16* kp = P + (rowbase + (ok ? kpos : 0)) * NIN + OFF_K + kvh * 64 + hi * 8;
        bf16x8 kf[4];
#pragma unroll
        for (int d0 = 0; d0 < 4; ++d0) { kf[d0] = *(const GAS bf16x8*)(kp + d0 * 16); if (!ok) kf[d0] = (bf16x8){0, 0, 0, 0, 0, 0, 0, 0}; }
        f32x16 acc = {};
#pragma unroll
        for (int d0 = 0; d0 < 4; ++d0) acc = __builtin_amdgcn_mfma_f32_32x32x16_bf16(kf[d0], qf[d0], acc, 0, 0, 0);
        s[i] = acc;
    }
    __syncthreads();
    const LAS float* bh = bs + (w & 3) * 128;
    float mx = -1e30f;
#pragma unroll
    for (int i = 0; i < 5; ++i)
#pragma unroll
        for (int r = 0; r < 16; ++r) { const int kl = crow(r, hi); const int dist = 128 - 32 * i + r32 - kl; const int kpos = q0 - 128 + 32 * i + kl;
            const bool valid = (dist >= 0) && (dist < 128) && (kpos >= 0);
            const float v = valid ? s[i][r] + bh[dist & 127] : -1e30f; s[i][r] = v; mx = fmaxf(mx, v); }
    mx = fmaxf(mx, __shfl_xor(mx, 32)); mx = fmaxf(mx, sink2);
    float l = 0.f;
#pragma unroll
    for (int i = 0; i < 5; ++i)
#pragma unroll
        for (int r = 0; r < 16; ++r) { const float p = __builtin_amdgcn_exp2f(s[i][r] - mx); s[i][r] = p; l += p; }
    l += __shfl_xor(l, 32); l += __builtin_amdgcn_exp2f(sink2 - mx);
    const float linv = 1.0f / l;
    f32x16 o[2]; o[0] = f32x16{}; o[1] = f32x16{};
#pragma unroll
    for (int ks = 0; ks < 10; ++ks) {
        const int i = ks >> 1, rb = (ks & 1) * 8;
        v4u pw; pw.x = pk2(s[i][rb + 0], s[i][rb + 1]); pw.y = pk2(s[i][rb + 2], s[i][rb + 3]); pw.z = pk2(s[i][rb + 4], s[i][rb + 5]); pw.w = pk2(s[i][rb + 6], s[i][rb + 7]);
        const bf16x8 pa = __builtin_bit_cast(bf16x8, pw);
        const int kidx = sub * 32 + 16 * ks + 4 * hi;
#pragma unroll
        for (int d0 = 0; d0 < 2; ++d0) { const LAS bf16* vp = vt + (32 * d0 + r32) * VT_PITCH + kidx;
            const v2u lo = *(const LAS v2u*)vp, hh = *(const LAS v2u*)(vp + 8);
            const v4u vv = (v4u){lo.x, lo.y, hh.x, hh.y};
            o[d0] = __builtin_amdgcn_mfma_f32_32x32x16_bf16(pa, __builtin_bit_cast(bf16x8, vv), o[d0], 0, 0, 0); }
    }
#pragma unroll
    for (int r = 0; r < 16; ++r) { const int q = crow(r, hi); const float li = __shfl(linv, q);
        const size_t row = rowbase + q0 + q;
#pragma unroll
        for (int d0 = 0; d0 < 2; ++d0) { const int col = hq * 64 + 32 * d0 + r32;
            const float g = bf2f(P[row * NIN + OFF_GA + col]);
            AC[row * KCAT + col] = (bf16)f2bf(o[d0][r] * li * g); } }
    __syncthreads();
}

constexpr int XC_PITCH = 136;
constexpr int R1_XC = 0, R1_G = 64 * XC_PITCH * 2  , R1_SEG = R1_G + CH * 256 * 4  , R1_END = R1_SEG + 4 * 128 * 2 * 4;
__device__ __forceinline__ float neg_expm1(float x) {
    if (x > -0.25f) { const float p = x * (1.0f + x * (0.5f + x * (0.16666667f + x * (0.041666668f + x * (0.0083333338f + x * 0.0013888889f))))); return -p; }
    return 1.0f - __builtin_amdgcn_exp2f(x * LOG2E);
}
__device__ __forceinline__ void rnn1_unit(Frame& F, const Args& a, int layer, int unit) {
    const int c = unit & (NCHUNK - 1), hb = (unit >> 6) & 15, b = unit >> 10;
    const bf16* P = (const bf16*)(F.ws + WS_P);
    const float* tab = (const float*)(F.ws + WS_TAB);
    LAS bf16* xc = (LAS bf16*)(F.lds + R1_XC); LAS float* G = (LAS float*)(F.lds + R1_G); LAS float* SEG = (LAS float*)(F.lds + R1_SEG);
    TID_LANE_WAVE();
    const int w = wave, r32 = lane & 31, hi = lane >> 5;
    const int t0 = c * CH; const size_t rowbase = (size_t)b * SEQ;
    const int ch0 = hb * RBD;
    { const int cch = tid & 15, rr = tid >> 4; const int cg = ch0 + cch * 8;
      const float* cw = a.in[2] + (size_t)layer * 4 * RW + cg; const float* cb = a.in[3] + (size_t)layer * RW + cg;
      float xin[5][8];
#pragma unroll
      for (int i = 0; i < 5; ++i) { const int t = t0 + 2 * rr - 3 + i;
          v4u v = (v4u){0u, 0u, 0u, 0u};
          if (t >= 0) v = *(const GAS v4u*)(P + (rowbase + t) * NIN + OFF_XR + cg);
          xin[i][0] = bflo(v.x); xin[i][1] = bfhi(v.x); xin[i][2] = bflo(v.y); xin[i][3] = bfhi(v.y); xin[i][4] = bflo(v.z); xin[i][5] = bfhi(v.z); xin[i][6] = bflo(v.w); xin[i][7] = bfhi(v.w); }
      float y0[8], y1[8];
#pragma unroll
      for (int e = 0; e < 8; ++e) { y0[e] = cb[e]; y1[e] = cb[e]; }
#pragma unroll
      for (int k = 0; k < 4; ++k) {
#pragma unroll
          for (int e = 0; e < 8; ++e) { const float wv = cw[(size_t)k * RW + e]; y0[e] += wv * xin[k][e]; y1[e] += wv * xin[k + 1][e]; } }
      v4u o0, o1; o0.x = pk2(y0[0], y0[1]); o0.y = pk2(y0[2], y0[3]); o0.z = pk2(y0[4], y0[5]); o0.w = pk2(y0[6], y0[7]);
      o1.x = pk2(y1[0], y1[1]); o1.y = pk2(y1[2], y1[3]); o1.z = pk2(y1[4], y1[5]); o1.w = pk2(y1[6], y1[7]);
      *(LAS v4u*)(xc + (2 * rr) * XC_PITCH + cch * 8) = o0; *(LAS v4u*)(xc + (2 * rr + 1) * XC_PITCH + cch * 8) = o1; }
    bf16x8 wf[8];
    { const bf16* wg = (const bf16*)(F.ws + WS_WG) + (((size_t)layer * RBLK + hb) * 256 + 32 * w + r32) * RBD + hi * 8;
#pragma unroll
      for (int s = 0; s < 8; ++s) wf[s] = *(const GAS bf16x8*)(wg + s * 16); }
    const int cj = ch0 + 32 * (w & 3) + r32;
    const float gbias = (w < 4) ? a.in[5][(size_t)layer * RW + cj] : a.in[7][(size_t)layer * RW + cj];
    const float n8 = tab[TAB_NEG8SP + layer * RW + cj];
    __syncthreads();
#pragma unroll
    for (int tt = 0; tt < 2; ++tt) {
        f32x16 acc = {};
#pragma unroll
        for (int s = 0; s < 8; ++s) { const bf16x8 af = *(const LAS bf16x8*)(xc + (32 * tt + r32) * XC_PITCH + 16 * s + 8 * hi);
            acc = __builtin_amdgcn_mfma_f32_32x32x16_bf16(af, wf[s], acc, 0, 0, 0); }
#pragma unroll
        for (int r = 0; r < 16; ++r) { const int t = 32 * tt + crow(r, hi); const float sg = pg8::sigm(acc[r] + gbias);
            G[t * 256 + 32 * w + r32] = (w < 4) ? sg * n8 : sg; }
    }
    __syncthreads();
    { const int cl = tid & 127, sgi = tid >> 7;
      float av[16], uv[16]; float Ap = 1.f, Hp = 0.f;
#pragma unroll
      for (int k = 0; k < 16; ++k) { const int t = 16 * sgi + k; const float la = G[t * 256 + cl], ig = G[t * 256 + 128 + cl], xv = bf2f(xc[t * XC_PITCH + cl]);
          const float av_ = __builtin_amdgcn_exp2f(la * LOG2E); const float mult = sqrtf(fmaxf(neg_expm1(2.0f * la), 0.f));
          av[k] = av_; uv[k] = mult * (ig * xv); Ap *= av_; Hp = av_ * Hp + uv[k]; }
      SEG[(sgi * 128 + cl) * 2] = Ap; SEG[(sgi * 128 + cl) * 2 + 1] = Hp;
      __syncthreads();
      float hin = 0.f, pin = 1.f;
      for (int s2 = 0; s2 < sgi; ++s2) { const float A2 = SEG[(s2 * 128 + cl) * 2], H2 = SEG[(s2 * 128 + cl) * 2 + 1]; hin = A2 * hin + H2; pin *= A2; }
      float* HL = (float*)(F.ws + WS_HL); float* PC = (float*)(F.ws + WS_PC);
#pragma unroll
      for (int k = 0; k < 16; ++k) { const size_t off = (rowbase + t0 + 16 * sgi + k) * RW + ch0 + cl; hin = av[k] * hin + uv[k]; pin *= av[k]; HL[off] = hin; PC[off] = pin; }
      if (sgi == 3) { float* SM = (float*)(F.ws + WS_SUM) + (((size_t)b * NCHUNK + c) * RW + ch0 + cl) * 2; SM[0] = pin; SM[1] = hin; }
    }
    __syncthreads();
}

__device__ __forceinline__ void rnn3_unit(Frame& F, int unit) {
    const int c = unit & (NCHUNK - 1), hb = (unit >> 6) & 15, b = unit >> 10;
    LAS float* PART = (LAS float*)F.lds; LAS float* CARRY = (LAS float*)(F.lds + 4096);
    TID_LANE_WAVE();
    const int cl = tid & 127, part = tid >> 7; const int ch0 = hb * RBD;
    { const float* SM = (const float*)(F.ws + WS_SUM) + ((size_t)b * NCHUNK * RW + ch0 + cl) * 2;
      const int k0 = (c * part) >> 2, k1 = (c * (part + 1)) >> 2; float Ap = 1.f, Hp = 0.f;
      for (int k = k0; k < k1; ++k) { const float A2 = SM[(size_t)k * RW * 2], H2 = SM[(size_t)k * RW * 2 + 1]; Hp = A2 * Hp + H2; Ap *= A2; }
      PART[(part * 128 + cl) * 2] = Ap; PART[(part * 128 + cl) * 2 + 1] = Hp; }
    __syncthreads();
    if (tid < 128) { float h = 0.f;
#pragma unroll
        for (int p = 0; p < 4; ++p) h = PART[(p * 128 + tid) * 2] * h + PART[(p * 128 + tid) * 2 + 1];
        CARRY[tid] = h; }
    __syncthreads();
    { const int cch = tid & 15, rr = tid >> 4; const size_t rowbase = (size_t)b * SEQ + (size_t)c * CH;
      const float* HL = (const float*)(F.ws + WS_HL); const float* PC = (const float*)(F.ws + WS_PC); const bf16* P = (const bf16*)(F.ws + WS_P); bf16* AC = (bf16*)(F.ws + WS_ACAT);
      float cy[8];
#pragma unroll
      for (int e = 0; e < 8; ++e) cy[e] = CARRY[cch * 8 + e];
#pragma unroll
      for (int q = 0; q < 2; ++q) { const size_t row = rowbase + 2 * rr + q; const size_t off = row * RW + ch0 + cch * 8;
          const f32x4 h0 = *(const GAS f32x4*)(HL + off), h1 = *(const GAS f32x4*)(HL + off + 4), p0 = *(const GAS f32x4*)(PC + off), p1 = *(const GAS f32x4*)(PC + off + 4);
          const v4u g = *(const GAS v4u*)(P + row * NIN + OFF_GR + ch0 + cch * 8);
          v4u o; o.x = pk2((h0[0] + p0[0] * cy[0]) * bflo(g.x), (h0[1] + p0[1] * cy[1]) * bfhi(g.x)); o.y = pk2((h0[2] + p0[2] * cy[2]) * bflo(g.y), (h0[3] + p0[3] * cy[3]) * bfhi(g.y));
          o.z = pk2((h1[0] + p1[0] * cy[4]) * bflo(g.z), (h1[1] + p1[1] * cy[5]) * bfhi(g.z)); o.w = pk2((h1[2] + p1[2] * cy[6]) * bflo(g.w), (h1[3] + p1[3] * cy[7]) * bfhi(g.w));
          *(GAS v4u*)(AC + row * KCAT + AW + ch0 + cch * 8) = o; } }
    __syncthreads();
}

__device__ __forceinline__ void ln_phase(Frame& F, const float* V, const float* g, const float* bta, float* out, bf16* xb) {
    TID_LANE_WAVE();
    const int gw = F.vcu * NWAVES + wave, NGW = F.G * NWAVES;
    for (int m = gw; m < M; m += NGW) {
        const GAS f32x4* vr = (const GAS f32x4*)(V + (size_t)m * D) + lane;
        f32x4 v[8]; float s = 0.f;
#pragma unroll
        for (int j = 0; j < 8; ++j) { v[j] = vr[64 * j]; s += (v[j].x + v[j].y) + (v[j].z + v[j].w); }
        const float mean = wave_sum(s) * (1.f / D); float s2 = 0.f;
#pragma unroll
        for (int j = 0; j < 8; ++j) { v[j] = v[j] - mean; s2 += (v[j].x * v[j].x + v[j].y * v[j].y) + (v[j].z * v[j].z + v[j].w * v[j].w); }
        const float rstd = 1.f / sqrtf(wave_sum(s2) * (1.f / D) + LN_EPS);
        GAS f32x4* orow = (GAS f32x4*)(out + (size_t)m * D) + lane; GAS v2u* o8 = (GAS v2u*)(xb + (size_t)m * D) + lane;
#pragma unroll
        for (int j = 0; j < 8; ++j) { const f32x4 gg = *((const GAS f32x4*)g + lane + 64 * j), bb = *((const GAS f32x4*)bta + lane + 64 * j);
            const f32x4 y = v[j] * rstd * gg + bb; orow[64 * j] = y; v2u w; w.x = pk2(y.x, y.y); w.y = pk2(y.z, y.w); o8[64 * j] = w; }
    }
}

constexpr int PH_PER_LAYER = 6, N_PHASES = 1 + DEPTH * PH_PER_LAYER;
__global__ void __launch_bounds__(NTHREADS, 2) hybrid_fwd(Args args) {
    extern __shared__ __attribute__((aligned(16))) unsigned char lds[];
    Frame F;
    F.lds = (LAS unsigned char*)lds;
    F.G = gridDim.x; { const int bx = blockIdx.x; F.vcu = (F.G % 8 == 0) ? (bx % 8) * (F.G / 8) + bx / 8 : bx; }
    F.ws = args.ws;
    for (int u = threadIdx.x; u < (LDS_BYTES - LDSCTL_OFF) / 4; u += NTHREADS) ((LAS unsigned*)(F.lds + LDSCTL_OFF))[u] = 0u;
    __syncthreads();
    const int lo = args.ph_lo, hi = args.ph_hi;
    XcdBarrier bar; bar.bar = (unsigned*)(F.ws + WS_CTL) + CW_BAR; bar.x = 0; bar.st = nullptr;
    const bool multi = (hi - lo) > 1;
    if (multi) bar = xcd_barrier_post((unsigned*)(F.ws + WS_CTL) + CW_BAR, (volatile LAS unsigned*)(F.lds + MISC_OFF) + 8);
#define IN(k) (lo <= (k) && (k) < hi)
#define SEAM(k) do { if (IN((k) + 1)) xcd_barrier(bar); } while (0)

    if (IN(0)) { p0_prologue(F, args); SEAM(0); }

    for (int l = 0; l < DEPTH; ++l) {
        const int pb = 1 + PH_PER_LAYER * l;
        const bf16* win = (const bf16*)(F.ws + WS_WIN) + (size_t)l * NIN * D; const bf16* wcat = (const bf16*)(F.ws + WS_WCAT) + (size_t)l * D * KCAT;
        const bf16* wout = (const bf16*)(F.ws + WS_WOUT) + (size_t)l * D * D;
        const float* xres = (l == 0) ? args.in[0] : (const float*)(F.ws + WS_X1);
        float* xnext = (l == DEPTH - 1) ? args.out : (float*)(F.ws + WS_X1);
        if (IN(pb + 0)) {
            pg8::Gemm g{(const bf16*)(F.ws + WS_XB), win, M, NIN, D}; pg8::StaticOrder S; S.init(M, NIN, F.G, (int)blockIdx.x);
            pg8::EpiProj E{(bf16*)(F.ws + WS_P), NIN, QSCALE};
            pg8::gemm_phase<pg8::EpiProj, pg8::StaticOrder, true>(F.lds, g, S, E);
            SEAM(pb + 0);
        }
        if (IN(pb + 1)) {
            for (int u = F.vcu; u < BATCH * NKVH * 64; u += F.G) attn_unit(F, l, u);
            for (int u = F.vcu; u < BATCH * RBLK * NCHUNK; u += F.G) rnn1_unit(F, args, l, u);
            SEAM(pb + 1);
        }
        if (IN(pb + 2)) {
            for (int u = F.vcu; u < BATCH * RBLK * NCHUNK; u += F.G) rnn3_unit(F, u);
            SEAM(pb + 2);
        }
        if (IN(pb + 3)) {
            pg8::Gemm g{(const bf16*)(F.ws + WS_ACAT), wcat, M, D, KCAT}; pg8::StaticOrder S; S.init(M, D, F.G, (int)blockIdx.x);
            pg8::EpiMixed E{(const bf16*)(F.ws + WS_P), NIN, OFF_MA, OFF_MR, (bf16*)(F.ws + WS_MIX), D, AW / 64};
            pg8::gemm_phase<pg8::EpiMixed, pg8::StaticOrder, true>(F.lds, g, S, E);
            SEAM(pb + 3);
        }
        if (IN(pb + 4)) {
            pg8::Gemm g{(const bf16*)(F.ws + WS_MIX), wout, M, D, D}; pg8::StaticOrder S; S.init(M, D, F.G, (int)blockIdx.x);
            pg8::EpiResF32 E{xres, (float*)(F.ws + WS_HL), D, ALPHA};
            pg8::gemm_phase<pg8::EpiResF32, pg8::StaticOrder, true>(F.lds, g, S, E);
            SEAM(pb + 4);
        }
        if (IN(pb + 5)) {
            ln_phase(F, (const float*)(F.ws + WS_HL), args.in[13] + (size_t)l * D, args.in[14] + (size_t)l * D, xnext, (bf16*)(F.ws + WS_XB));
            SEAM(pb + 5);
        }
    }
#undef IN
#undef SEAM
}

extern "C" void kernel_launch(void* const* d_in, const int* in_sizes, int n_in, void* d_out, int out_size, void* d_ws, size_t ws_size, hipStream_t stream) {
    static int grid = 0;
    if (grid == 0) {
        if (n_in != 16 || in_sizes[0] != M * D || out_size != M * D || ws_size < WS_END) { fprintf(stderr, "kernel_launch: unexpected shapes / workspace (%d inputs, ws %zu, need %zu)\n", n_in, ws_size, (size_t)WS_END); grid = -1; return; }
        int dev = 0, cus = 0, per_cu = 0;
        if (hipGetDevice(&dev) != hipSuccess || hipDeviceGetAttribute(&cus, hipDeviceAttributeMultiprocessorCount, dev) != hipSuccess) { grid = -1; return; }
        if (hipFuncSetAttribute((const void*)hybrid_fwd, hipFuncAttributeMaxDynamicSharedMemorySize, LDS_BYTES) != hipSuccess) { fprintf(stderr, "kernel_launch: hipFuncSetAttribute failed\n"); grid = -1; return; }
        if (hipOccupancyMaxActiveBlocksPerMultiprocessor(&per_cu, (const void*)hybrid_fwd, NTHREADS, LDS_BYTES) != hipSuccess || per_cu < 1) { fprintf(stderr, "kernel_launch: occupancy query says %d\n", per_cu); }
        (void)hipGetLastError();
        grid = cus;
    }
    if (grid < 0) return;
    (void)hipMemsetAsync((char*)d_ws + WS_CTL, 0, CTL_ZERO_BYTES, stream);
    Args a{};
    for (int i = 0; i < 16; ++i) a.in[i] = (const float*)d_in[i];
    a.out = (float*)d_out; a.ws = (unsigned char*)d_ws;
#if MK_N_LAUNCHES == 1
    a.ph_lo = 0; a.ph_hi = N_PHASES;
    hipLaunchKernelGGL(hybrid_fwd, dim3(grid), dim3(NTHREADS), LDS_BYTES, stream, a);
#else
    for (int p = 0; p < N_PHASES; ++p) { a.ph_lo = p; a.ph_hi = p + 1; hipLaunchKernelGGL(hybrid_fwd, dim3(grid), dim3(NTHREADS), LDS_BYTES, stream, a); }
#endif
}
```
